# Optimizing an MI355X kernel written in HIP

```python
import jax, jax.numpy as jnp
from jax import lax
import numpy as np

D_MODEL = 1024
BATCH = 4
SEQ = 8192
DEPTH = 1

GRID_W = 64
CTX_LEN = 256
HEAD_DIM = 64
N_HEADS_TOTAL = D_MODEL // HEAD_DIM
ATT_HEADS = N_HEADS_TOTAL // 2
ATT_KV_HEADS = ATT_HEADS // 4
WINDOW = 128
BLOCK = 128
ROPE_BASE = 10000.0
GLA_HEADS = N_HEADS_TOTAL - ATT_HEADS
GLA_DV = HEAD_DIM
GLA_DK = HEAD_DIM // 2
GLA_CHUNK = 64
GATE_RANK = 16
GATE_TAU = 16.0
MIX_WIDTH = ATT_HEADS * HEAD_DIM + GLA_HEADS * GLA_DV
FFN_HIDDEN = -(-8 * D_MODEL // (3 * 256)) * 256
SPLIT_SIZES = (ATT_HEADS * HEAD_DIM, ATT_KV_HEADS * HEAD_DIM, ATT_KV_HEADS * HEAD_DIM,
               GLA_HEADS * GLA_DK, GLA_HEADS * GLA_DK, GLA_HEADS * GLA_DV, GLA_HEADS * GLA_DV,
               GATE_RANK, GATE_RANK)
IN_COLS = sum(SPLIT_SIZES)
NEG_INF = -1e30

kernel_name = 'hybrid_window_gqa_gla_dit_block'


def rmsnorm(x, gain, eps=1e-6):
    x32 = x.astype(jnp.float32)
    y = x32 * lax.rsqrt(jnp.mean(x32 * x32, axis=-1, keepdims=True) + eps)
    return y.astype(x.dtype) * gain


def modulate(h, shift, scale):
    return h * (1.0 + scale) + shift


def heads(t, n):
    return t.reshape(t.shape[:-1] + (n, t.shape[-1] // n))


def flip(t):
    return jnp.flip(t, axis=1)


def split_columns(p):
    idx = np.cumsum(SPLIT_SIZES)[:-1].tolist()
    return jnp.split(p, idx, axis=-1)


def axial_rope_tables(n_tokens):
    ROWS = n_tokens // GRID_W
    row = jnp.repeat(jnp.arange(ROWS), GRID_W).astype(jnp.float32)
    col = jnp.tile(jnp.arange(GRID_W), ROWS).astype(jnp.float32)
    half = HEAD_DIM // 2
    inv_freq = ROPE_BASE ** (-jnp.arange(0, half, 2, dtype=jnp.float32) / half)
    ang_r = row[:, None] * inv_freq[None, :]
    ang_c = col[:, None] * inv_freq[None, :]
    ang = jnp.concatenate([ang_r, ang_r, ang_c, ang_c], axis=-1)
    return jnp.cos(ang), jnp.sin(ang)


def apply_rope(x, cos, sin):
    shp = x.shape
    xr = x.reshape(shp[:-1] + (2, 2, HEAD_DIM // 4))
    rot = jnp.concatenate([-xr[..., 1:2, :], xr[..., 0:1, :]], axis=-2).reshape(shp)
    return x * cos[:, None, :].astype(x.dtype) + rot * sin[:, None, :].astype(x.dtype)


def softmax_with_sink(logits, sink):
    sink_col = jnp.broadcast_to(sink, logits.shape[:-1] + (1,))
    p = jax.nn.softmax(jnp.concatenate([logits, sink_col], axis=-1), axis=-1)
    return p[..., :-1]


def window_attention(q, k, v, k_ctx, v_ctx, sink):
    B, S, H, dh = q.shape
    G = H // ATT_KV_HEADS
    nb = S // BLOCK
    scale = dh ** -0.5
    qb = q.reshape(B, nb, BLOCK, ATT_KV_HEADS, G, dh)
    pad = ((0, 0), (BLOCK, BLOCK), (0, 0), (0, 0))
    kp = jnp.pad(k, pad).reshape(B, nb + 2, BLOCK, ATT_KV_HEADS, dh)
    vp = jnp.pad(v, pad).reshape(B, nb + 2, BLOCK, ATT_KV_HEADS, dh)
    kw = jnp.concatenate([kp[:, :-2], kp[:, 1:-1], kp[:, 2:]], axis=2)
    vw = jnp.concatenate([vp[:, :-2], vp[:, 1:-1], vp[:, 2:]], axis=2)
    s_win = jnp.einsum('bnqhgd,bnkhd->bhgnqk', qb, kw).astype(jnp.float32) * scale
    qpos = jnp.arange(nb)[:, None] * BLOCK + jnp.arange(BLOCK)[None, :]
    kpos = (jnp.arange(nb)[:, None] - 1) * BLOCK + jnp.arange(3 * BLOCK)[None, :]
    rel = kpos[:, None, :] - qpos[:, :, None]
    mask = (jnp.abs(rel) <= WINDOW) & (kpos[:, None, :] >= 0) & (kpos[:, None, :] < S)
    s_win = jnp.where(mask, s_win, NEG_INF)
    s_ctx = jnp.einsum('bnqhgd,bchd->bhgnqc', qb, k_ctx).astype(jnp.float32) * scale
    sink_b = sink.astype(jnp.float32).reshape(ATT_KV_HEADS, G)[None, :, :, None, None, None]
    p = softmax_with_sink(jnp.concatenate([s_win, s_ctx], axis=-1), sink_b).astype(v.dtype)
    n_win = 3 * BLOCK
    o = (jnp.einsum('bhgnqk,bnkhd->bnqhgd', p[..., :n_win], vw)
         + jnp.einsum('bhgnqc,bchd->bnqhgd', p[..., n_win:], v_ctx))
    return o.reshape(B, S, H * dh)


def context_attention(q, k, v, sink):
    B, C, H, dh = q.shape
    G = H // ATT_KV_HEADS
    qg = q.reshape(B, C, ATT_KV_HEADS, G, dh)
    s = jnp.einsum('bqhgd,bkhd->bhgqk', qg, k).astype(jnp.float32) * dh ** -0.5
    sink_b = sink.astype(jnp.float32).reshape(ATT_KV_HEADS, G)[None, :, :, None, None]
    p = softmax_with_sink(s, sink_b).astype(v.dtype)
    return jnp.einsum('bhgqk,bkhd->bqhgd', p, v).reshape(B, C, H * dh)


def log_decay(z, w_gate, b_gate):
    logits = (z @ w_gate + b_gate).astype(jnp.float32)
    return heads(jax.nn.log_sigmoid(logits) / GATE_TAU, GLA_HEADS)


def gla_chunked(q, k, v, log_a, s0):
    B, T, H, DK = q.shape
    DV = v.shape[-1]
    n = T // GLA_CHUNK
    f32 = jnp.float32
    qc = q.astype(f32).reshape(B, n, GLA_CHUNK, H, DK)
    kc = k.astype(f32).reshape(B, n, GLA_CHUNK, H, DK)
    vc = v.astype(f32).reshape(B, n, GLA_CHUNK, H, DV)
    b = jnp.cumsum(log_a.astype(f32).reshape(B, n, GLA_CHUNK, H, DK), axis=2)
    b_last = b[:, :, -1:]
    q_dec = qc * jnp.exp(b)
    k_inv = kc * jnp.exp(-b)
    lower = jnp.tril(jnp.ones((GLA_CHUNK, GLA_CHUNK), dtype=bool))
    A = jnp.where(lower, jnp.einsum('bnihk,bnjhk->bnhij', q_dec, k_inv), 0.0)
    intra = jnp.einsum('bnhij,bnjhv->bnihv', A, vc)
    dS = jnp.einsum('bnjhk,bnjhv->bnhkv', kc * jnp.exp(b_last - b), vc)
    decay = jnp.exp(b_last[:, :, 0])

    def step(state, inp):
        d, ds = inp
        return d[..., None] * state + ds, state

    s_final, s_before = lax.scan(step, s0, (jnp.moveaxis(decay, 1, 0), jnp.moveaxis(dS, 1, 0)))
    inter = jnp.einsum('bnihk,nbhkv->bnihv', q_dec, s_before)
    o = (intra + inter).reshape(B, T, H, DV).astype(v.dtype)
    return o, s_final


def gla_final_state(k, v, log_a):
    b = jnp.cumsum(log_a.astype(jnp.float32), axis=1)
    w = jnp.exp(b[:, -1:] - b)
    return jnp.einsum('bthk,bthv->bhkv', k.astype(jnp.float32) * w, v.astype(jnp.float32))


def gla_output(o, gate, g_norm):
    return rmsnorm(o, g_norm).reshape(gate.shape) * jax.nn.silu(gate)


def swiglu(h, w_in, w_out):
    g, u = jnp.split(h @ w_in, 2, axis=-1)
    return (jax.nn.silu(g) * u) @ w_out


def setup_inputs(seed: int = 0) -> dict:
    key = jax.random.key(seed)
    ks = jax.random.split(key, 24)
    L, D = DEPTH, D_MODEL
    nrm = jax.random.normal
    f32 = jnp.float32
    return {
        'x': nrm(ks[0], (BATCH, SEQ, D), f32),
        'c': nrm(ks[1], (BATCH, D), f32),
        'ctx': nrm(ks[2], (BATCH, CTX_LEN, D), f32),
        'c_ctx': nrm(ks[3], (D,), f32),
        'w_ada': nrm(ks[4], (L, D, 6 * D), f32) * (0.5 * D ** -0.5),
        'b_ada': nrm(ks[5], (L, 6 * D), f32) * 0.02,
        'g_pre_mix': 1.0 + 0.05 * nrm(ks[6], (L, D), f32),
        'g_post_mix': 1.0 + 0.05 * nrm(ks[7], (L, D), f32),
        'g_pre_ffn': 1.0 + 0.05 * nrm(ks[8], (L, D), f32),
        'g_post_ffn': 1.0 + 0.05 * nrm(ks[9], (L, D), f32),
        'w_in': nrm(ks[10], (L, D, IN_COLS), f32) * D ** -0.5,
        'attn_sink': 0.5 * nrm(ks[11], (L, ATT_HEADS), f32),
        'w_gate_fwd': nrm(ks[12], (L, GATE_RANK, GLA_HEADS * GLA_DK), f32) * GATE_RANK ** -0.5,
        'b_gate_fwd': 0.5 * nrm(ks[13], (L, GLA_HEADS * GLA_DK), f32),
        'w_gate_bwd': nrm(ks[14], (L, GATE_RANK, GLA_HEADS * GLA_DK), f32) * GATE_RANK ** -0.5,
        'b_gate_bwd': 0.5 * nrm(ks[15], (L, GLA_HEADS * GLA_DK), f32),
        'g_gla_norm': 1.0 + 0.05 * nrm(ks[16], (L, GLA_DV), f32),
        'w_out': nrm(ks[17], (L, MIX_WIDTH, D), f32) * MIX_WIDTH ** -0.5,
        'w_ffn_in': nrm(ks[18], (L, D, 2 * FFN_HIDDEN), f32) * D ** -0.5,
        'w_ffn_out': nrm(ks[19], (L, FFN_HIDDEN, D), f32) * FFN_HIDDEN ** -0.5,
    }


def reference(x, c, ctx, c_ctx, w_ada, b_ada, g_pre_mix, g_post_mix, g_pre_ffn, g_post_ffn,
              w_in, attn_sink, w_gate_fwd, b_gate_fwd, w_gate_bwd, b_gate_bwd, g_gla_norm,
              w_out, w_ffn_in, w_ffn_out):
    B, S, _ = x.shape
    cos, sin = axial_rope_tables(S)
    zero_state = jnp.zeros((B, GLA_HEADS, GLA_DK, GLA_DV), jnp.float32)
    for l in range(DEPTH):
        need_ctx_out = l < DEPTH - 1
        ada = jax.nn.silu(c) @ w_ada[l] + b_ada[l]
        ada_c = jax.nn.silu(c_ctx) @ w_ada[l] + b_ada[l]
        sh1, sc1, gt1, sh2, sc2, gt2 = jnp.split(ada[:, None, :], 6, axis=-1)
        sh1c, sc1c, gt1c, sh2c, sc2c, gt2c = jnp.split(ada_c, 6, axis=-1)

        h = modulate(rmsnorm(x, g_pre_mix[l]), sh1, sc1)
        hc = modulate(rmsnorm(ctx, g_pre_mix[l]), sh1c, sc1c)
        q, k, v, gq, gk, gv, gg, zf, zb = split_columns(h @ w_in[l])
        qc, kc, vc, gqc, gkc, gvc, ggc, zfc, zbc = split_columns(hc @ w_in[l])

        q_h = apply_rope(heads(q, ATT_HEADS), cos, sin)
        k_h = apply_rope(heads(k, ATT_KV_HEADS), cos, sin)
        v_h = heads(v, ATT_KV_HEADS)
        kc_h = heads(kc, ATT_KV_HEADS)
        vc_h = heads(vc, ATT_KV_HEADS)
        attn_lat = window_attention(q_h, k_h, v_h, kc_h, vc_h, attn_sink[l])

        gkc_h = heads(gkc, GLA_HEADS)
        gvc_h = heads(gvc, GLA_HEADS)
        la_fc = log_decay(zfc, w_gate_fwd[l], b_gate_fwd[l])
        la_bc = log_decay(zbc, w_gate_bwd[l], b_gate_bwd[l])
        if need_ctx_out:
            gqc_h = heads(gqc, GLA_HEADS) * GLA_DK ** -0.5
            oc_f, s_f = gla_chunked(gqc_h, gkc_h, gvc_h, la_fc, zero_state)
            oc_b, s_b = gla_chunked(flip(gqc_h), flip(gkc_h), flip(gvc_h), flip(la_bc), zero_state)
            gla_ctx = gla_output(oc_f + flip(oc_b), ggc, g_gla_norm[l])
            attn_ctx = context_attention(heads(qc, ATT_HEADS), kc_h, vc_h, attn_sink[l])
        else:
            s_f = gla_final_state(gkc_h, gvc_h, la_fc)
            s_b = gla_final_state(flip(gkc_h), flip(gvc_h), flip(la_bc))

        gq_h = heads(gq, GLA_HEADS) * GLA_DK ** -0.5
        gk_h = heads(gk, GLA_HEADS)
        gv_h = heads(gv, GLA_HEADS)
        la_f = log_decay(zf, w_gate_fwd[l], b_gate_fwd[l])
        la_b = log_decay(zb, w_gate_bwd[l], b_gate_bwd[l])
        o_f, _ = gla_chunked(gq_h, gk_h, gv_h, la_f, s_f)
        o_b, _ = gla_chunked(flip(gq_h), flip(gk_h), flip(gv_h), flip(la_b), s_b)
        gla_lat = gla_output(o_f + flip(o_b), gg, g_gla_norm[l])

        y = jnp.concatenate([attn_lat, gla_lat], axis=-1) @ w_out[l]
        x = x + gt1 * rmsnorm(y, g_post_mix[l])

        f = swiglu(modulate(rmsnorm(x, g_pre_ffn[l]), sh2, sc2), w_ffn_in[l], w_ffn_out[l])
        x = x + gt2 * rmsnorm(f, g_post_ffn[l])

        if need_ctx_out:
            yc = jnp.concatenate([attn_ctx, gla_ctx], axis=-1) @ w_out[l]
            ctx = ctx + gt1c * rmsnorm(yc, g_post_mix[l])
            fc = swiglu(modulate(rmsnorm(ctx, g_pre_ffn[l]), sh2c, sc2c), w_ffn_in[l], w_ffn_out[l])
            ctx = ctx + gt2c * rmsnorm(fc, g_post_ffn[l])
    return x
```

```cpp
#include <hip/hip_runtime.h>
#include <hip/hip_cooperative_groups.h>
#include <cstdio>
#include <cstdint>
namespace cg = cooperative_groups;
#define MK_LAUNCHES 11
namespace pg8 {
#define PG8_LAS __attribute__((address_space(3)))
typedef unsigned short bf16_t;
typedef short bf16x8 __attribute__((ext_vector_type(8)));
typedef float f32x4 __attribute__((ext_vector_type(4)));
typedef unsigned u32x4 __attribute__((ext_vector_type(4)));
constexpr int BM = 256, BK = 64, HALF = 128, HTB = HALF * BK * 2  , STAGE_BYTES = 8 * HTB, NXCD = 8, WGM = 8;

__host__ __device__ __forceinline__ int lds_byte(int r, int c) { const int st = (r >> 4) * 2 + (c >> 5), rr = r & 15, cc = c & 31, ob = rr * 64 + cc * 2; return st * 1024 + (ob ^ (((ob >> 9) & 1) << 5)); }
__host__ __device__ __forceinline__ void stage_rc(int b, int& R, int& C) { const int st = b / 1024, sb = b % 1024, swz = sb ^ (((sb >> 9) & 1) << 5); R = (st >> 1) * 16 + swz / 64; C = (st & 1) * 32 + (swz % 64) / 2; }
__host__ __device__ __forceinline__ int perm32(int rho) { const int n = rho >> 4, i = rho & 15; return 8 * (i >> 2) + 4 * n + (i & 3); }

struct Unit { int pm, pn; };
struct Gemm { const bf16_t* A; const bf16_t* Bt; int M, N, K; };

struct StaticOrder {
    int nM, nN, nwg, G, c;
    __host__ __device__ void init(int M, int N, int G_, int c_) { nM = M / BM; nN = N / BM; nwg = nM * nN; G = G_; c = c_; }
    __host__ __device__ bool next(int i, Unit& u) const {
        const long L = (long)i * G + c; if (L >= nwg) return false;
        int wgid = (int)L; { const int q = nwg / NXCD, r = nwg % NXCD, xcd = wgid % NXCD, off = wgid / NXCD; wgid = (xcd < r ? xcd * (q + 1) : r * (q + 1) + (xcd - r) * q) + off; }
        const int nig = WGM * nN, gid = wgid / nig, fm = gid * WGM, gsz = (nM - fm) < WGM ? (nM - fm) : WGM;
        u.pm = fm + ((wgid % nig) % gsz); u.pn = (wgid % nig) / gsz; return true;
    }
    __device__ __forceinline__ void a_ready(const Unit&) const {}
    __device__ __forceinline__ void done(const Unit&) const {}
};

__device__ __forceinline__ unsigned cvt_pk_bf16(float lo, float hi) { unsigned r; asm volatile("v_cvt_pk_bf16_f32 %0, %1, %2" : "=v"(r) : "v"(lo), "v"(hi)); return r; }
typedef float f32x2 __attribute__((ext_vector_type(2)));
typedef unsigned u32x4 __attribute__((ext_vector_type(4)));
struct EpiPlain {
    static constexpr bool PERM = true, AFTER_DRAIN = false;
    bf16_t* O; int ldc;
    __device__ __forceinline__ void operator()(const f32x4 (&acc)[2][2][4][2], const Unit& u, int wr, int wc, int fr, int fq) const {
        const int row0 = u.pm * BM + wr * 64 + fr; const int col0 = u.pn * BM + wc * 32 + 8 * fq;
#pragma unroll
        for (int ai = 0; ai < 2; ++ai)
#pragma unroll
            for (int m = 0; m < 4; ++m) { bf16_t* rowp = O + (size_t)(row0 + ai * HALF + m * 16) * ldc + col0;
#pragma unroll
                for (int bj = 0; bj < 2; ++bj) { const f32x4 v0 = acc[ai][bj][m][0], v1 = acc[ai][bj][m][1];
                    u32x4 w; w.x = cvt_pk_bf16(v0[0], v0[1]); w.y = cvt_pk_bf16(v0[2], v0[3]); w.z = cvt_pk_bf16(v1[0], v1[1]); w.w = cvt_pk_bf16(v1[2], v1[3]);
                    *(u32x4*)(rowp + bj * HALF) = w; } }
    }
};
__device__ __forceinline__ float silu_f(float g) { return g * __builtin_amdgcn_rcpf(1.0f + __expf(-g)); }
struct EpiSwiGLU {
    static constexpr bool PERM = true, AFTER_DRAIN = false;
    bf16_t* O; int ldc;
    __device__ __forceinline__ void operator()(const f32x4 (&acc)[2][2][4][2], const Unit& u, int wr, int wc, int fr, int fq) const {
        const int row0 = u.pm * BM + wr * 64 + fr; const int col0 = u.pn * HALF + wc * 32 + 8 * fq;
#pragma unroll
        for (int ai = 0; ai < 2; ++ai)
#pragma unroll
            for (int m = 0; m < 4; ++m) { bf16_t* rowp = O + (size_t)(row0 + ai * HALF + m * 16) * ldc + col0;
                const f32x4 g0 = acc[ai][0][m][0], g1 = acc[ai][0][m][1], u0 = acc[ai][1][m][0], u1 = acc[ai][1][m][1];
                u32x4 w; w.x = cvt_pk_bf16(silu_f(g0[0]) * u0[0], silu_f(g0[1]) * u0[1]); w.y = cvt_pk_bf16(silu_f(g0[2]) * u0[2], silu_f(g0[3]) * u0[3]);
                w.z = cvt_pk_bf16(silu_f(g1[0]) * u1[0], silu_f(g1[1]) * u1[1]); w.w = cvt_pk_bf16(silu_f(g1[2]) * u1[2], silu_f(g1[3]) * u1[3]);
                *(u32x4*)rowp = w; }
    }
};
template <class Epi, class Sched, bool ALIGN_EPI = false, bool SP2 = false>
__device__ __forceinline__ void gemm_phase(PG8_LAS unsigned char* lds, const Gemm g, const Sched& S, const Epi& E) {
    const int tid = threadIdx.x, wid = __builtin_amdgcn_readfirstlane(tid >> 6), lane = tid & 63, wr = wid >> 2, wc = wid & 3, fr = lane & 15, fq = lane >> 4;
    const int K = g.K, nt = K / BK;
    unsigned voffA[2], voffB[2];
#pragma unroll
    for (int i = 0; i < 2; ++i) { int R, C; stage_rc(tid * 16 + i * 8192, R, C); const int Rb = Epi::PERM ? ((R & ~31) + perm32(R & 31)) : R;
        voffA[i] = (unsigned)(R * K + C) * 2u; voffB[i] = (unsigned)(Rb * K + C) * 2u; }
    const size_t kstep = (size_t)(BK * 2);
    const size_t hstep = (size_t)HALF * K * 2;
    const size_t tstep = 2 * hstep;
    const unsigned ldsw = (unsigned)wid * 1024u;
    const int aoff = lds_byte(wr * 64 + fr, fq * 8), boff = lds_byte(wc * 32 + fr, fq * 8);
#define PG8_SA(b, h) (((b) * 2 + (h)) * HTB)
#define PG8_SB(b, h) ((4 + (b) * 2 + (h)) * HTB)
#define PG8_STAGE(bufoff, gbase, voff) do { _Pragma("unroll") for (int _i = 0; _i < 2; ++_i) \
        __builtin_amdgcn_global_load_lds((const unsigned*)((const char*)(gbase) + (voff)[_i]), (PG8_LAS unsigned*)(lds + (bufoff) + ldsw + _i * 8192), 16, 0, 0); } while (0)
#define PG8_LDA(dst, b, h) do { _Pragma("unroll") for (int m = 0; m < 4; ++m) _Pragma("unroll") for (int k = 0; k < 2; ++k) dst[m][k] = *(const PG8_LAS bf16x8*)(lds + PG8_SA(b, h) + aoff + m * 2048 + k * 1024); } while (0)
#define PG8_LDB(dst, b, h) do { _Pragma("unroll") for (int n = 0; n < 2; ++n) _Pragma("unroll") for (int k = 0; k < 2; ++k) dst[n][k] = *(const PG8_LAS bf16x8*)(lds + PG8_SB(b, h) + boff + n * 2048 + k * 1024); } while (0)
#define PG8_MMA(ai, bj, At, Bt) do { __builtin_amdgcn_s_setprio(1); _Pragma("unroll") for (int m = 0; m < 4; ++m) _Pragma("unroll") for (int n = 0; n < 2; ++n) _Pragma("unroll") for (int k = 0; k < 2; ++k) \
        acc[ai][bj][m][n] = __builtin_amdgcn_mfma_f32_16x16x32_bf16(Bt[n][k], At[m][k], acc[ai][bj][m][n], 0, 0, 0); __builtin_amdgcn_s_setprio(0); } while (0)
#define PG8_WAIT_V(n) asm volatile("s_waitcnt vmcnt(" #n ")" ::: "memory")
#define PG8_WAIT_L(n) asm volatile("s_waitcnt lgkmcnt(" #n ")" ::: "memory")
#define PG8_BAR __builtin_amdgcn_s_barrier()
#define PG8_SCHED __builtin_amdgcn_sched_barrier(0)
    Unit cur, nxt; int ui = 0;
    if (!S.next(0, cur)) return;
    f32x4 acc[2][2][4][2];
#pragma unroll
    for (int a = 0; a < 2; ++a)
#pragma unroll
        for (int b = 0; b < 2; ++b)
#pragma unroll
            for (int m = 0; m < 4; ++m)
#pragma unroll
                for (int n = 0; n < 2; ++n) acc[a][b][m][n] = (f32x4){0.f, 0.f, 0.f, 0.f};
    bf16x8 At[4][2], B0[2][2], B1[2][2];
    const char* cA = (const char*)g.A + (size_t)cur.pm * tstep; const char* cB = (const char*)g.Bt + (size_t)cur.pn * tstep;
    S.a_ready(cur);
    if constexpr (SP2) {
        PG8_STAGE(PG8_SB(0, 0), cB, voffB); PG8_STAGE(PG8_SB(0, 1), cB + hstep, voffB); PG8_STAGE(PG8_SA(0, 0), cA, voffA); PG8_STAGE(PG8_SA(0, 1), cA + hstep, voffA);
        if (wr == 1) PG8_BAR;
        PG8_WAIT_V(2); PG8_BAR;
        PG8_STAGE(PG8_SB(1, 0), cB + kstep, voffB); PG8_STAGE(PG8_SA(1, 0), cA + kstep, voffA); PG8_STAGE(PG8_SB(1, 1), cB + hstep + kstep, voffB);
        PG8_WAIT_V(6); PG8_BAR;
    } else {
        PG8_STAGE(PG8_SB(0, 0), cB, voffB); PG8_STAGE(PG8_SA(0, 0), cA, voffA); PG8_STAGE(PG8_SB(0, 1), cB + hstep, voffB); PG8_STAGE(PG8_SA(0, 1), cA + hstep, voffA);
        if (wr == 1) PG8_BAR;
        PG8_WAIT_V(4); PG8_BAR;
        PG8_STAGE(PG8_SB(1, 0), cB + kstep, voffB); PG8_STAGE(PG8_SA(1, 0), cA + kstep, voffA); PG8_STAGE(PG8_SB(1, 1), cB + hstep + kstep, voffB);
        PG8_WAIT_V(6); PG8_BAR;
    }
    for (;;) {
        const bool has_next = S.next(ui + 1, nxt);
        const char* nA = has_next ? (const char*)g.A + (size_t)nxt.pm * tstep : cA; const char* nB = has_next ? (const char*)g.Bt + (size_t)nxt.pn * tstep : cB;
        for (int t = 0; t < nt; t += 2) {
            const bool last = (t == nt - 2);
            const char* a1 = cA + (size_t)(t + 1) * kstep;
            const char* a2 = last ? nA : cA + (size_t)(t + 2) * kstep; const char* b2 = last ? nB : cB + (size_t)(t + 2) * kstep;
            const char* a3 = a2 + kstep; const char* b3 = b2 + kstep;
            if (last && has_next) S.a_ready(nxt);
            if constexpr (SP2) {
            PG8_LDB(B0, 0, 0); PG8_LDB(B1, 0, 1); PG8_SCHED; PG8_LDA(At, 0, 0); PG8_STAGE(PG8_SA(1, 1), a1 + hstep, voffA);
            PG8_WAIT_V(8); PG8_WAIT_L(0); PG8_BAR; PG8_MMA(0, 0, At, B0); PG8_MMA(0, 1, At, B1); PG8_BAR; PG8_SCHED;
            PG8_LDA(At, 0, 1); PG8_STAGE(PG8_SB(0, 0), b2, voffB); PG8_STAGE(PG8_SB(0, 1), b2 + hstep, voffB); PG8_STAGE(PG8_SA(0, 0), a2, voffA);
            PG8_WAIT_V(8); PG8_WAIT_L(0); PG8_BAR; PG8_MMA(1, 0, At, B0); PG8_MMA(1, 1, At, B1); PG8_BAR; PG8_SCHED;
            PG8_LDB(B0, 1, 0); PG8_LDB(B1, 1, 1); PG8_SCHED; PG8_LDA(At, 1, 0); PG8_STAGE(PG8_SA(0, 1), a2 + hstep, voffA);
            PG8_WAIT_V(8); PG8_WAIT_L(0); PG8_BAR; PG8_MMA(0, 0, At, B0); PG8_MMA(0, 1, At, B1); PG8_BAR; PG8_SCHED;
            PG8_LDA(At, 1, 1); PG8_STAGE(PG8_SB(1, 0), b3, voffB); PG8_STAGE(PG8_SB(1, 1), b3 + hstep, voffB); PG8_STAGE(PG8_SA(1, 0), a3, voffA);
            PG8_WAIT_V(8); PG8_WAIT_L(0); PG8_BAR; PG8_MMA(1, 0, At, B0); PG8_MMA(1, 1, At, B1); PG8_BAR; PG8_SCHED;
            } else {
            PG8_LDB(B0, 0, 0); PG8_SCHED; PG8_LDA(At, 0, 0); PG8_STAGE(PG8_SA(1, 1), a1 + hstep, voffA);
            PG8_WAIT_L(8); PG8_BAR; PG8_WAIT_L(0); PG8_MMA(0, 0, At, B0); PG8_BAR; PG8_SCHED;
            PG8_LDB(B1, 0, 1); PG8_STAGE(PG8_SB(0, 0), b2, voffB);
            PG8_BAR; PG8_WAIT_L(0); PG8_MMA(0, 1, At, B1); PG8_BAR;
            PG8_LDA(At, 0, 1); PG8_STAGE(PG8_SA(0, 0), a2, voffA);
            PG8_BAR; PG8_WAIT_L(0); PG8_MMA(1, 0, At, B0); PG8_BAR; PG8_SCHED;
            PG8_STAGE(PG8_SB(0, 1), b2 + hstep, voffB);
            PG8_WAIT_V(6); PG8_BAR; PG8_MMA(1, 1, At, B1); PG8_BAR;
            PG8_LDB(B0, 1, 0); PG8_SCHED; PG8_LDA(At, 1, 0); PG8_STAGE(PG8_SA(0, 1), a2 + hstep, voffA);
            PG8_WAIT_L(8); PG8_BAR; PG8_WAIT_L(0); PG8_MMA(0, 0, At, B0); PG8_BAR; PG8_SCHED;
            PG8_LDB(B1, 1, 1); PG8_STAGE(PG8_SB(1, 0), b3, voffB);
            PG8_BAR; PG8_WAIT_L(0); PG8_MMA(0, 1, At, B1); PG8_BAR;
            PG8_LDA(At, 1, 1); PG8_STAGE(PG8_SA(1, 0), a3, voffA);
            PG8_BAR; PG8_WAIT_L(0); PG8_MMA(1, 0, At, B0); PG8_BAR; PG8_SCHED;
            PG8_STAGE(PG8_SB(1, 1), b3 + hstep, voffB);
            PG8_WAIT_V(6); PG8_BAR; PG8_MMA(1, 1, At, B1); PG8_BAR;
            }
        }
        if constexpr (ALIGN_EPI) { if (wr == 0) PG8_BAR; }
        if constexpr (!Epi::AFTER_DRAIN) { E(acc, cur, wr, wc, fr, fq); S.done(cur); }
        if (!has_next) break;
#pragma unroll
        for (int a = 0; a < 2; ++a)
#pragma unroll
            for (int b = 0; b < 2; ++b)
#pragma unroll
                for (int m = 0; m < 4; ++m)
#pragma unroll
                    for (int n = 0; n < 2; ++n) acc[a][b][m][n] = (f32x4){0.f, 0.f, 0.f, 0.f};
        cur = nxt; cA = nA; cB = nB; ++ui;
        if constexpr (ALIGN_EPI) { if (wr == 1) PG8_BAR; }
    }
    PG8_WAIT_V(0);
    if constexpr (!ALIGN_EPI) { if (wr == 0) PG8_BAR; }
    PG8_BAR;
    if constexpr (Epi::AFTER_DRAIN) { E.fused(acc, cur, wr, wc, fr, fq, lds, wid, lane); S.done(cur); }
#undef PG8_SA
#undef PG8_SB
#undef PG8_STAGE
#undef PG8_LDA
#undef PG8_LDB
#undef PG8_MMA
#undef PG8_WAIT_V
#undef PG8_WAIT_L
#undef PG8_BAR
#undef PG8_SCHED
}
}
#define LAS __attribute__((address_space(3)))
typedef unsigned short bf16;
typedef short bf16x8 __attribute__((ext_vector_type(8)));
typedef short s16x4 __attribute__((ext_vector_type(4)));
typedef float f32x4 __attribute__((ext_vector_type(4)));
typedef unsigned u32x4 __attribute__((ext_vector_type(4)));
typedef unsigned u32x2 __attribute__((ext_vector_type(2)));
typedef LAS unsigned char lds8;

constexpr int NB = 4, SEQ = 8192, DM = 1024, CTXL = 256, FF = 2816;
constexpr int ML = NB * SEQ;
constexpr int MC = NB * CTXL;
constexpr int MT = ML + MC;
constexpr int NP = 2560;
constexpr int C_K = 0, C_V = 128, C_GK = 256, C_GV = 512, C_Z = 1024, C_Q = 1280, C_GQ = 1792, C_GG = 2048;
constexpr int NCH = 132;
constexpr float LOG2E = 1.4426950408889634f;
constexpr float QSCALE = 0.125f * LOG2E;
constexpr float EPS = 1e-6f;

constexpr size_t MiB = 1u << 20;
constexpr size_t WS_ADA = 0;
constexpr size_t WS_TAB = 256 * 1024;
constexpr size_t WS_WIN = 1 * MiB;
constexpr size_t WS_WOUT = 6 * MiB;
constexpr size_t WS_WFI = 8 * MiB;
constexpr size_t WS_WFO = 19 * MiB;
constexpr size_t WS_H = 27 * MiB;
constexpr size_t WS_P = 93 * MiB;
constexpr size_t WS_DS = 258 * MiB;
constexpr size_t WS_DEC = 324 * MiB;
constexpr size_t WS_SB = 326 * MiB;
constexpr size_t WS_MIX = 358 * MiB;
constexpr size_t WS_Y = 422 * MiB;
constexpr size_t WS_HM = 93 * MiB;
constexpr size_t WS_END = 486 * MiB;
constexpr int LDS_BYTES = 147456;

struct Args {
    const float *x, *c, *ctx, *c_ctx, *w_ada, *b_ada, *g_pre_mix, *g_post_mix, *g_pre_ffn, *g_post_ffn, *w_in, *attn_sink,
                *w_gate_fwd, *b_gate_fwd, *w_gate_bwd, *b_gate_bwd, *g_gla_norm, *w_out, *w_ffn_in, *w_ffn_out;
    float* out; unsigned char* ws; int ph_lo, ph_hi;
};

__device__ __forceinline__ float bf2f(short s) { return __uint_as_float(((unsigned)(unsigned short)s) << 16); }
typedef float f32x2_t __attribute__((ext_vector_type(2))); typedef __bf16 bf16x2_t __attribute__((ext_vector_type(2)));
__device__ __forceinline__ unsigned cvtpk(float lo, float hi) { f32x2_t v = {lo, hi}; bf16x2_t b = __builtin_convertvector(v, bf16x2_t); return __builtin_bit_cast(unsigned, b); }
__device__ __forceinline__ unsigned short f2bf(float f) { return (unsigned short)(cvtpk(f, 0.f) & 0xffffu); }
__device__ __forceinline__ float wave_sum(float v) {
#pragma unroll
    for (int o = 1; o < 64; o <<= 1) v += __shfl_xor(v, o);
    return v;
}
__device__ __forceinline__ float fexp2(float x) { return __builtin_amdgcn_exp2f(x); }
__device__ __forceinline__ float silu(float g) { return g * __builtin_amdgcn_rcpf(1.0f + __expf(-g)); }

__device__ __forceinline__ void transpose_item(const float* W, int K, int N, bf16* WT, int k0, int n0, int drow0, LAS float* scr, int lane) {
#pragma unroll 8
    for (int i = 0; i < 32; ++i) { const int kk = 2 * i + (lane >> 5); scr[kk * 33 + (lane & 31)] = W[(size_t)(k0 + kk) * N + n0 + (lane & 31)]; }
    asm volatile("s_waitcnt lgkmcnt(0)" ::: "memory");
    const int c = lane & 7;
#pragma unroll
    for (int j = 0; j < 4; ++j) { const int n = (lane >> 3) + 8 * j; const LAS float* s = scr + (8 * c) * 33 + n;
        u32x4 o; o.x = cvtpk(s[0 * 33], s[1 * 33]); o.y = cvtpk(s[2 * 33], s[3 * 33]); o.z = cvtpk(s[4 * 33], s[5 * 33]); o.w = cvtpk(s[6 * 33], s[7 * 33]);
        *(u32x4*)(WT + (size_t)(drow0 + n) * K + k0 + 8 * c) = o; }
    asm volatile("s_waitcnt lgkmcnt(0)" ::: "memory");
}
__device__ __forceinline__ int win_dest(int n0) {
    if (n0 < 512) return C_Q + n0;
    if (n0 < 640) return C_K + (n0 - 512);
    if (n0 < 768) return C_V + (n0 - 640);
    if (n0 < 1024) return C_GQ + (n0 - 768);
    if (n0 < 1280) return C_GK + (n0 - 1024);
    if (n0 < 1792) return C_GV + (n0 - 1280);
    if (n0 < 2304) return C_GG + (n0 - 1792);
    return C_Z + (n0 - 2304);
}
__device__ __forceinline__ void p0_prologue(const Args& a, lds8* lds) {
    const int tid = threadIdx.x, lane = tid & 63, wave = tid >> 6;
    unsigned char* ws = a.ws;
    float* ADA = (float*)(ws + WS_ADA); float* TAB = (float*)(ws + WS_TAB);
    bf16* WIN = (bf16*)(ws + WS_WIN); bf16* WOUT = (bf16*)(ws + WS_WOUT); bf16* WFI = (bf16*)(ws + WS_WFI); bf16* WFO = (bf16*)(ws + WS_WFO);
    {
        LAS float* sc = (LAS float*)lds;
        LAS float* red = (LAS float*)(lds + 20480);
        bool have = false;
        for (int cb = blockIdx.x; cb < 192; cb += gridDim.x) {
            if (!have) {
                for (int i = 0; i < 10; ++i) { const int idx = tid + 512 * i; const int r = idx >> 10, k = idx & 1023; const float v = r < 4 ? a.c[r * 1024 + k] : a.c_ctx[k]; sc[idx] = v / (1.0f + __expf(-v)); }
                have = true;
            }
            __syncthreads();
            const int col = tid & 31, ks = tid >> 5, n0 = cb * 32;
            float acc[5] = {0.f, 0.f, 0.f, 0.f, 0.f};
#pragma unroll 8
            for (int kk = 0; kk < 64; ++kk) { const int k = ks * 64 + kk; const float w = a.w_ada[(size_t)k * 6144 + n0 + col];
#pragma unroll
                for (int r = 0; r < 5; ++r) acc[r] += sc[r * 1024 + k] * w; }
#pragma unroll
            for (int r = 0; r < 5; ++r) red[(ks * 5 + r) * 32 + col] = acc[r];
            __syncthreads();
            if (tid < 160) { const int r = tid >> 5, cc = tid & 31; float s = a.b_ada[n0 + cc];
                for (int k2 = 0; k2 < 16; ++k2) s += red[(k2 * 5 + r) * 32 + cc];
                ADA[r * 6144 + n0 + cc] = s; }
        }
        __syncthreads();
    }
    {
        LAS float* scr = (LAS float*)(lds + wave * 16384);
        const int gw = blockIdx.x * 8 + wave, NGW = gridDim.x * 8;
        constexpr int I_IN = 16 * 73, I_OUT = 16 * 32, I_FI = 16 * 176, I_FO = 44 * 32;
        constexpr int NITEMS = I_IN + I_OUT + I_FI + I_FO;
        for (int it = gw; it < NITEMS; it += NGW) {
            int r = it;
            if (r < I_IN) { const int kb = r / 73, nb = r % 73; transpose_item(a.w_in, 1024, 2336, WIN, 64 * kb, 32 * nb, win_dest(32 * nb), scr, lane); continue; } r -= I_IN;
            if (r < I_OUT) { const int kb = r / 32, nb = r % 32; transpose_item(a.w_out, 1024, 1024, WOUT, 64 * kb, 32 * nb, 32 * nb, scr, lane); continue; } r -= I_OUT;
            if (r < I_FI) { const int kb = r / 176, nb = r % 176; const int n0 = 32 * nb; const int isu = n0 >= FF ? 1 : 0; const int j = n0 - isu * FF;
                transpose_item(a.w_ffn_in, 1024, 2 * FF, WFI, 64 * kb, n0, (j >> 7) * 256 + isu * 128 + (j & 127), scr, lane); continue; } r -= I_FI;
            { const int kb = r / 32, nb = r % 32; transpose_item(a.w_ffn_out, FF, 1024, WFO, 64 * kb, 32 * nb, 32 * nb, scr, lane); }
        }
    }
    {
        const int gt = blockIdx.x * 512 + tid;
        if (gt < 192 * 16) { const int p = gt >> 4, i = gt & 15; const float pos = (float)(p < 128 ? p : p - 128);
            const float f = exp2f(-(float)i * (13.287712379549449f / 16.0f));
            float ang = pos * f; const float TWO_PI = 6.283185307179586f; ang -= TWO_PI * rintf(ang * (1.0f / TWO_PI));
            TAB[p * 32 + i] = __cosf(ang); TAB[p * 32 + 16 + i] = __sinf(ang); }
    }
    {
        u32x4* z = (u32x4*)(WIN + (size_t)(C_Z + 32) * 1024); const int n16 = (C_Q - C_Z - 32) * 1024 * 2 / 16;
        for (int i = blockIdx.x * 512 + tid; i < n16; i += gridDim.x * 512) z[i] = (u32x4){0u, 0u, 0u, 0u};
    }
}

__device__ __forceinline__ void p1_rows(const Args& a) {
    const int lane = threadIdx.x & 63, wave = threadIdx.x >> 6;
    const float* ADA = (const float*)(a.ws + WS_ADA); bf16* H = (bf16*)(a.ws + WS_H);
    for (int m = blockIdx.x * 8 + wave; m < MT; m += gridDim.x * 8) {
        const float* src = m < ML ? a.x + (size_t)m * DM : a.ctx + (size_t)(m - ML) * DM;
        const float* ad = ADA + (m < ML ? (m >> 13) : 4) * 6144;
        f32x4 v[4]; float s = 0.f;
#pragma unroll
        for (int j = 0; j < 4; ++j) { v[j] = *(const f32x4*)(src + 256 * j + 4 * lane); s += (v[j].x * v[j].x + v[j].y * v[j].y) + (v[j].z * v[j].z + v[j].w * v[j].w); }
        const float rstd = 1.0f / sqrtf(wave_sum(s) * (1.0f / DM) + EPS);
#pragma unroll
        for (int j = 0; j < 4; ++j) { const int k = 256 * j + 4 * lane;
            const f32x4 g = *(const f32x4*)(a.g_pre_mix + k), sh = *(const f32x4*)(ad + k), sc = *(const f32x4*)(ad + 1024 + k);
            const f32x4 o = (v[j] * rstd) * g * (sc + 1.0f) + sh;
            u32x2 w; w.x = cvtpk(o.x, o.y); w.y = cvtpk(o.z, o.w); *(u32x2*)(H + (size_t)m * DM + k) = w; }
    }
}
__device__ __forceinline__ void p7_rows(const Args& a) {
    const int lane = threadIdx.x & 63, wave = threadIdx.x >> 6;
    const float* ADA = (const float*)(a.ws + WS_ADA); bf16* H = (bf16*)(a.ws + WS_H); const bf16* Y = (const bf16*)(a.ws + WS_Y);
    for (int m = blockIdx.x * 8 + wave; m < ML; m += gridDim.x * 8) {
        const float* ad = ADA + (m >> 13) * 6144;
        f32x4 y[4], xv[4]; float s = 0.f;
#pragma unroll
        for (int j = 0; j < 4; ++j) { const int k = 256 * j + 4 * lane; const u32x2 w = *(const u32x2*)(Y + (size_t)m * DM + k);
            y[j] = (f32x4){__uint_as_float(w.x << 16), __uint_as_float(w.x & 0xffff0000u), __uint_as_float(w.y << 16), __uint_as_float(w.y & 0xffff0000u)};
            xv[j] = *(const f32x4*)(a.x + (size_t)m * DM + k);
            s += (y[j].x * y[j].x + y[j].y * y[j].y) + (y[j].z * y[j].z + y[j].w * y[j].w); }
        const float ry = 1.0f / sqrtf(wave_sum(s) * (1.0f / DM) + EPS);
        float s1 = 0.f;
#pragma unroll
        for (int j = 0; j < 4; ++j) { const int k = 256 * j + 4 * lane;
            const f32x4 g = *(const f32x4*)(a.g_post_mix + k), gt = *(const f32x4*)(ad + 2048 + k);
            xv[j] = xv[j] + gt * ((y[j] * ry) * g);
            *(f32x4*)(a.out + (size_t)m * DM + k) = xv[j];
            s1 += (xv[j].x * xv[j].x + xv[j].y * xv[j].y) + (xv[j].z * xv[j].z + xv[j].w * xv[j].w); }
        const float r1 = 1.0f / sqrtf(wave_sum(s1) * (1.0f / DM) + EPS);
#pragma unroll
        for (int j = 0; j < 4; ++j) { const int k = 256 * j + 4 * lane;
            const f32x4 g = *(const f32x4*)(a.g_pre_ffn + k), sh = *(const f32x4*)(ad + 3072 + k), sc = *(const f32x4*)(ad + 4096 + k);
            const f32x4 o = (xv[j] * r1) * g * (sc + 1.0f) + sh;
            u32x2 w; w.x = cvtpk(o.x, o.y); w.y = cvtpk(o.z, o.w); *(u32x2*)(H + (size_t)m * DM + k) = w; }
    }
}
__device__ __forceinline__ void p10_rows(const Args& a) {
    const int lane = threadIdx.x & 63, wave = threadIdx.x >> 6;
    const float* ADA = (const float*)(a.ws + WS_ADA); const bf16* Y = (const bf16*)(a.ws + WS_Y);
    for (int m = blockIdx.x * 8 + wave; m < ML; m += gridDim.x * 8) {
        const float* ad = ADA + (m >> 13) * 6144;
        f32x4 y[4], xv[4]; float s = 0.f;
#pragma unroll
        for (int j = 0; j < 4; ++j) { const int k = 256 * j + 4 * lane; const u32x2 w = *(const u32x2*)(Y + (size_t)m * DM + k);
            y[j] = (f32x4){__uint_as_float(w.x << 16), __uint_as_float(w.x & 0xffff0000u), __uint_as_float(w.y << 16), __uint_as_float(w.y & 0xffff0000u)};
            xv[j] = *(const f32x4*)(a.out + (size_t)m * DM + k);
            s += (y[j].x * y[j].x + y[j].y * y[j].y) + (y[j].z * y[j].z + y[j].w * y[j].w); }
        const float ry = 1.0f / sqrtf(wave_sum(s) * (1.0f / DM) + EPS);
#pragma unroll
        for (int j = 0; j < 4; ++j) { const int k = 256 * j + 4 * lane;
            const f32x4 g = *(const f32x4*)(a.g_post_ffn + k), gt = *(const f32x4*)(ad + 5120 + k);
            *(f32x4*)(a.out + (size_t)m * DM + k) = xv[j] + gt * ((y[j] * ry) * g); }
    }
}
#define MFMA16(A, B, C) __builtin_amdgcn_mfma_f32_16x16x32_bf16((A), (B), (C), 0, 0, 0)
__device__ __forceinline__ bf16x8 ld8g(const bf16* p) { return __builtin_bit_cast(bf16x8, *(const u32x4*)p); }
__device__ __forceinline__ bf16x8 rope8(bf16x8 x, bf16x8 xp, const float* TAB, int tp, int gsel, float scale) {
    const float* t = TAB + tp * 32 + 8 * (gsel & 1);
    const f32x4 c0 = *(const f32x4*)(t), c1 = *(const f32x4*)(t + 4), s0 = *(const f32x4*)(t + 16), s1 = *(const f32x4*)(t + 20);
    const float sg = gsel < 2 ? -scale : scale;
    float o[8];
#pragma unroll
    for (int j = 0; j < 8; ++j) { const float cs = j < 4 ? c0[j & 3] : c1[j & 3], sn = j < 4 ? s0[j & 3] : s1[j & 3]; o[j] = bf2f(x[j]) * cs * scale + bf2f(xp[j]) * sn * sg; }
    u32x4 w; w.x = cvtpk(o[0], o[1]); w.y = cvtpk(o[2], o[3]); w.z = cvtpk(o[4], o[5]); w.w = cvtpk(o[6], o[7]);
    return __builtin_bit_cast(bf16x8, w);
}
__device__ __forceinline__ void attn_phase(const Args& a, lds8* lds) {
    const int tid = threadIdx.x, lane = tid & 63, wave = tid >> 6, c = lane & 15, g = lane >> 4;
    const bf16* P = (const bf16*)(a.ws + WS_P); bf16* MIX = (bf16*)(a.ws + WS_MIX); const float* TAB = (const float*)(a.ws + WS_TAB);
    lds8* KT = lds; lds8* VT = lds + 9216;
    for (int u = blockIdx.x; u < 1024; u += gridDim.x) {
        const int b = u >> 8, kvh = (u >> 7) & 1, qb = u & 127, q0 = qb * 64;
        const int hq = kvh * 4 + (wave >> 1), qs = (wave & 1) * 32;
        bf16x8 Bq[2][2];
#pragma unroll
        for (int nt = 0; nt < 2; ++nt)
#pragma unroll
            for (int ks = 0; ks < 2; ++ks) { const int pos = q0 + qs + 16 * nt + c; const bf16* qp = P + (size_t)(b * SEQ + pos) * NP + C_Q + hq * 64 + 32 * ks;
                const bf16x8 x = ld8g(qp + 8 * g), xp = ld8g(qp + 8 * (g ^ 2));
                Bq[nt][ks] = rope8(x, xp, TAB, ks == 0 ? (pos >> 6) : 128 + (pos & 63), g, QSCALE); }
        float m_run[2] = {-1e30f, -1e30f}, l_run[2] = {0.f, 0.f};
        f32x4 O[4][2];
#pragma unroll
        for (int dt = 0; dt < 4; ++dt) { O[dt][0] = (f32x4){0.f, 0.f, 0.f, 0.f}; O[dt][1] = (f32x4){0.f, 0.f, 0.f, 0.f}; }
        for (int t = 0; t < 9; ++t) {
            const bool isctx = t < 4; const int k0 = isctx ? 0 : q0 - 128 + 64 * (t - 4);
            if (!isctx && (k0 + 63 < 0 || k0 >= SEQ)) continue;
            __syncthreads();
            {
                const int kk = tid >> 3, d0 = (tid & 7) * 8; bf16x8 kv, vv;
                if (isctx) { const bf16* rp = P + (size_t)(ML + b * CTXL + t * 64 + kk) * NP; kv = ld8g(rp + C_K + kvh * 64 + d0); vv = ld8g(rp + C_V + kvh * 64 + d0); }
                else { const int pos = k0 + kk;
                    if (pos >= 0 && pos < SEQ) { const bf16* rp = P + (size_t)(b * SEQ + pos) * NP; const int gs = (d0 >> 3) & 3, ks = d0 >> 5;
                        const bf16x8 x = ld8g(rp + C_K + kvh * 64 + d0), xp = ld8g(rp + C_K + kvh * 64 + (d0 ^ 16));
                        kv = rope8(x, xp, TAB, ks == 0 ? (pos >> 6) : 128 + (pos & 63), gs, 1.0f); vv = ld8g(rp + C_V + kvh * 64 + d0); }
                    else { kv = (bf16x8){0, 0, 0, 0, 0, 0, 0, 0}; vv = kv; } }
                *(LAS bf16x8*)(KT + kk * 144 + d0 * 2) = kv;
#pragma unroll
                for (int j = 0; j < 8; ++j) *(LAS short*)(VT + (d0 + j) * 144 + kk * 2) = vv[j];
            }
            __syncthreads();
            f32x4 S[4][2];
#pragma unroll
            for (int mt = 0; mt < 4; ++mt) {
                const bf16x8 A0 = *(const LAS bf16x8*)(KT + (16 * mt + c) * 144 + g * 16), A1 = *(const LAS bf16x8*)(KT + (16 * mt + c) * 144 + 64 + g * 16);
#pragma unroll
                for (int nt = 0; nt < 2; ++nt) { S[mt][nt] = MFMA16(A0, Bq[nt][0], ((f32x4){0.f, 0.f, 0.f, 0.f})); S[mt][nt] = MFMA16(A1, Bq[nt][1], S[mt][nt]); }
            }
            if (!isctx) {
#pragma unroll
                for (int mt = 0; mt < 4; ++mt)
#pragma unroll
                    for (int nt = 0; nt < 2; ++nt)
#pragma unroll
                        for (int r = 0; r < 4; ++r) { const int kp = k0 + 16 * mt + 4 * g + r, dl = kp - (q0 + qs + 16 * nt + c);
                            const bool ok = dl >= -128 && dl <= 128 && kp >= 0 && kp < SEQ; S[mt][nt][r] = ok ? S[mt][nt][r] : -1e30f; }
            }
            bf16x8 Bp[2][2];
#pragma unroll
            for (int nt = 0; nt < 2; ++nt) {
                float mx = -1e30f;
#pragma unroll
                for (int mt = 0; mt < 4; ++mt)
#pragma unroll
                    for (int r = 0; r < 4; ++r) mx = fmaxf(mx, S[mt][nt][r]);
                mx = fmaxf(mx, __shfl_xor(mx, 16)); mx = fmaxf(mx, __shfl_xor(mx, 32));
                const float mn = fmaxf(m_run[nt], mx), alpha = fexp2(m_run[nt] - mn); m_run[nt] = mn;
                float ps = 0.f;
#pragma unroll
                for (int mt = 0; mt < 4; ++mt)
#pragma unroll
                    for (int r = 0; r < 4; ++r) { const float p = fexp2(S[mt][nt][r] - mn); S[mt][nt][r] = p; ps += p; }
                l_run[nt] = l_run[nt] * alpha + ps;
#pragma unroll
                for (int dt = 0; dt < 4; ++dt) O[dt][nt] = O[dt][nt] * alpha;
#pragma unroll
                for (int s = 0; s < 2; ++s) { u32x4 w; w.x = cvtpk(S[2 * s][nt][0], S[2 * s][nt][1]); w.y = cvtpk(S[2 * s][nt][2], S[2 * s][nt][3]);
                    w.z = cvtpk(S[2 * s + 1][nt][0], S[2 * s + 1][nt][1]); w.w = cvtpk(S[2 * s + 1][nt][2], S[2 * s + 1][nt][3]); Bp[nt][s] = __builtin_bit_cast(bf16x8, w); }
            }
#pragma unroll
            for (int dt = 0; dt < 4; ++dt)
#pragma unroll
                for (int s = 0; s < 2; ++s) {
                    const s16x4 lo = *(const LAS s16x4*)(VT + (16 * dt + c) * 144 + (32 * s + 4 * g) * 2), hi = *(const LAS s16x4*)(VT + (16 * dt + c) * 144 + (32 * s + 16 + 4 * g) * 2);
                    const bf16x8 Av = __builtin_shufflevector(lo, hi, 0, 1, 2, 3, 4, 5, 6, 7);
                    O[dt][0] = MFMA16(Av, Bp[0][s], O[dt][0]); O[dt][1] = MFMA16(Av, Bp[1][s], O[dt][1]); }
        }
        const float sk = a.attn_sink[hq] * LOG2E;
#pragma unroll
        for (int nt = 0; nt < 2; ++nt) {
            float l = l_run[nt]; l += __shfl_xor(l, 16); l += __shfl_xor(l, 32); l += fexp2(sk - m_run[nt]);
            const float inv = 1.0f / l;
            bf16* op = MIX + (size_t)(b * SEQ + q0 + qs + 16 * nt + c) * DM + hq * 64 + 4 * g;
#pragma unroll
            for (int dt = 0; dt < 4; ++dt) { u32x2 w; w.x = cvtpk(O[dt][nt][0] * inv, O[dt][nt][1] * inv); w.y = cvtpk(O[dt][nt][2] * inv, O[dt][nt][3] * inv); *(u32x2*)(op + 16 * dt) = w; }
        }
    }
}

constexpr int L_QD = 0, L_KI = 10240, L_KIT = 20480, L_VT = 29696, L_TOT = 38912, L_BL = 40960, L_SSQ = 41216;
__device__ __forceinline__ void gla_front(const Args& a, lds8* lds, int row0, int h, bool want_qd, bool want_kit) {
    const int tid = threadIdx.x, dir = tid >> 8, seg = (tid >> 5) & 7, kd = tid & 31;
    const bf16* P = (const bf16*)(a.ws + WS_P);
    const float* wgp = (dir ? a.w_gate_bwd : a.w_gate_fwd) + h * 32 + kd;
    float wg[16];
#pragma unroll
    for (int r = 0; r < 16; ++r) wg[r] = wgp[r * 256];
    const float bias = (dir ? a.b_gate_bwd : a.b_gate_fwd)[h * 32 + kd];
    float cs[8]; float run = 0.f;
#pragma unroll
    for (int s = 0; s < 8; ++s) { const int tok = dir == 0 ? 8 * seg + s : 8 * seg + 7 - s;
        const bf16* zp = P + (size_t)(row0 + tok) * NP + C_Z + dir * 16;
        const bf16x8 z0 = ld8g(zp), z1 = ld8g(zp + 8);
        float x = bias;
#pragma unroll
        for (int r = 0; r < 8; ++r) { x += bf2f(z0[r]) * wg[r]; x += bf2f(z1[r]) * wg[8 + r]; }
        const float la = (fminf(x, 0.f) - __logf(1.0f + __expf(-fabsf(x)))) * (1.0f / 16.0f);
        run += la; cs[s] = run; }
    LAS float* TOT = (LAS float*)(lds + L_TOT); LAS float* BL = (LAS float*)(lds + L_BL);
    TOT[(dir * 8 + seg) * 32 + kd] = run;
    __syncthreads();
    float off = 0.f, total = 0.f;
#pragma unroll
    for (int s2 = 0; s2 < 8; ++s2) { const float t = TOT[(dir * 8 + s2) * 32 + kd]; total += t; if (dir == 0 ? (s2 < seg) : (s2 > seg)) off += t; }
    if (seg == 0) BL[dir * 32 + kd] = total;
#pragma unroll
    for (int s = 0; s < 8; ++s) { const int tok = dir == 0 ? 8 * seg + s : 8 * seg + 7 - s;
        const bf16* rp = P + (size_t)(row0 + tok) * NP;
        const float bb = cs[s] + off; const float E = __expf(bb), Ei = __expf(-bb);
        const float qv = bf2f((short)rp[C_GQ + h * 32 + kd]), kv = bf2f((short)rp[C_GK + h * 32 + kd]);
        const unsigned short kq = f2bf(kv * Ei);
        if (want_qd) { *(LAS unsigned short*)(lds + L_QD + dir * 5120 + tok * 80 + kd * 2) = f2bf(qv * E * 0.17677669529663687f);
                       *(LAS unsigned short*)(lds + L_KI + dir * 5120 + tok * 80 + kd * 2) = kq; }
        if (want_kit) *(LAS unsigned short*)(lds + L_KIT + dir * 4608 + kd * 144 + tok * 2) = kq; }
    {   const int tok = tid >> 3, v0 = (tid & 7) * 8; const bf16x8 vv = ld8g(P + (size_t)(row0 + tok) * NP + C_GV + h * 64 + v0);
#pragma unroll
        for (int j = 0; j < 8; ++j) *(LAS short*)(lds + L_VT + (v0 + j) * 144 + tok * 2) = vv[j]; }
    __syncthreads();
}
__device__ __forceinline__ void gla_local_phase(const Args& a, lds8* lds) {
    const int tid = threadIdx.x, lane = tid & 63, wave = tid >> 6, c = lane & 15, g = lane >> 4;
    float* DS = (float*)(a.ws + WS_DS); float* DEC = (float*)(a.ws + WS_DEC);
    for (int u = blockIdx.x; u < NB * NCH * 8; u += gridDim.x) {
        const int h = u & 7, n = (u >> 3) % NCH, b = (u >> 3) / NCH;
        const int row0 = n < 128 ? b * SEQ + n * 64 : ML + b * CTXL + (n - 128) * 64;
        gla_front(a, lds, row0, h, false, true);
        const int dir = wave >> 2, vt = wave & 3;
        const size_t base = (size_t)(((b * NCH + n) * 8 + h) * 2 + dir);
        const LAS float* BL = (const LAS float*)(lds + L_BL);
#pragma unroll
        for (int kt = 0; kt < 2; ++kt) { f32x4 acc = {0.f, 0.f, 0.f, 0.f};
#pragma unroll
            for (int s = 0; s < 2; ++s) { const bf16x8 Av = *(const LAS bf16x8*)(lds + L_VT + (16 * vt + c) * 144 + (32 * s + 8 * g) * 2);
                const bf16x8 Bk = *(const LAS bf16x8*)(lds + L_KIT + dir * 4608 + (16 * kt + c) * 144 + (32 * s + 8 * g) * 2); acc = MFMA16(Av, Bk, acc); }
            const int kdim = 16 * kt + c; const float e = __expf(BL[dir * 32 + kdim]);
#pragma unroll
            for (int r = 0; r < 4; ++r) DS[base * 2048 + (16 * vt + 4 * g + r) * 32 + kdim] = acc[r] * e; }
        if (tid < 64) { const int d2 = tid >> 5, kd = tid & 31; DEC[((size_t)(((b * NCH + n) * 8 + h) * 2 + d2)) * 32 + kd] = __expf(BL[d2 * 32 + kd]); }
    }
}
__device__ __forceinline__ void gla_scan_phase(const Args& a) {
    const float* DS = (const float*)(a.ws + WS_DS); const float* DEC = (const float*)(a.ws + WS_DEC); bf16* SB = (bf16*)(a.ws + WS_SB);
    for (int gt = blockIdx.x * 512 + threadIdx.x; gt < 64 * 2048; gt += gridDim.x * 512) {
        const int e = gt & 2047, item = gt >> 11, dir = item & 1, h = (item >> 1) & 7, b = item >> 4, kd = e & 31;
        float S = 0.f;
        for (int i0 = 0; i0 < NCH; i0 += 12) { float d[12], dc[12];
#pragma unroll
            for (int q = 0; q < 12; ++q) { const int i = i0 + q; const int cidx = dir == 0 ? (i < 4 ? 128 + i : i - 4) : (i < 4 ? 131 - i : 131 - i);
                const size_t base = (size_t)(((b * NCH + cidx) * 8 + h) * 2 + dir); d[q] = DS[base * 2048 + e]; dc[q] = DEC[base * 32 + kd]; }
#pragma unroll
            for (int q = 0; q < 12; ++q) { const int i = i0 + q; const int cidx = dir == 0 ? (i < 4 ? 128 + i : i - 4) : (i < 4 ? 131 - i : 131 - i);
                if (cidx < 128) SB[((size_t)(((b * 128 + cidx) * 8 + h) * 2 + dir)) * 2048 + e] = f2bf(S);
                S = dc[q] * S + d[q]; }
        }
    }
}
__device__ __forceinline__ void gla_out_phase(const Args& a, lds8* lds) {
    const int tid = threadIdx.x, lane = tid & 63, wave = tid >> 6, c = lane & 15, g = lane >> 4;
    const bf16* P = (const bf16*)(a.ws + WS_P); const bf16* SB = (const bf16*)(a.ws + WS_SB); bf16* MIX = (bf16*)(a.ws + WS_MIX);
    for (int u = blockIdx.x; u < NB * 128 * 8; u += gridDim.x) {
        const int h = u & 7, n = (u >> 3) & 127, b = u >> 10; const int row0 = b * SEQ + n * 64;
        gla_front(a, lds, row0, h, true, false);
        const int it = wave & 3, vh = wave >> 2;
        f32x4 O[2] = {(f32x4){0.f, 0.f, 0.f, 0.f}, (f32x4){0.f, 0.f, 0.f, 0.f}};
#pragma unroll
        for (int dir = 0; dir < 2; ++dir) {
            const bf16x8 Bq = *(const LAS bf16x8*)(lds + L_QD + dir * 5120 + (16 * it + c) * 80 + g * 16);
            f32x4 AT[4];
#pragma unroll
            for (int jt = 0; jt < 4; ++jt) { const bool need = dir == 0 ? (jt <= it) : (jt >= it);
                AT[jt] = (f32x4){0.f, 0.f, 0.f, 0.f};
                if (need) { const bf16x8 Ak = *(const LAS bf16x8*)(lds + L_KI + dir * 5120 + (16 * jt + c) * 80 + g * 16);
                    AT[jt] = MFMA16(Ak, Bq, AT[jt]);
                    if (jt == it) {
#pragma unroll
                        for (int r = 0; r < 4; ++r) { const int j = 4 * g + r; const bool keep = dir == 0 ? (j <= c) : (j >= c); AT[jt][r] = keep ? AT[jt][r] : 0.f; } } } }
            bf16x8 Bp[2];
#pragma unroll
            for (int s = 0; s < 2; ++s) { u32x4 w; w.x = cvtpk(AT[2 * s][0], AT[2 * s][1]); w.y = cvtpk(AT[2 * s][2], AT[2 * s][3]);
                w.z = cvtpk(AT[2 * s + 1][0], AT[2 * s + 1][1]); w.w = cvtpk(AT[2 * s + 1][2], AT[2 * s + 1][3]); Bp[s] = __builtin_bit_cast(bf16x8, w); }
            const bf16* sbp = SB + ((size_t)(((b * 128 + n) * 8 + h) * 2 + dir)) * 2048;
#pragma unroll
            for (int vi = 0; vi < 2; ++vi) { const int vrow = 16 * (2 * vh + vi) + c;
#pragma unroll
                for (int s = 0; s < 2; ++s) { const s16x4 lo = *(const LAS s16x4*)(lds + L_VT + vrow * 144 + (32 * s + 4 * g) * 2), hi = *(const LAS s16x4*)(lds + L_VT + vrow * 144 + (32 * s + 16 + 4 * g) * 2);
                    O[vi] = MFMA16(__builtin_shufflevector(lo, hi, 0, 1, 2, 3, 4, 5, 6, 7), Bp[s], O[vi]); }
                const bf16x8 As = ld8g(sbp + vrow * 32 + 8 * g);
                O[vi] = MFMA16(As, Bq, O[vi]); }
        }
        float ss = 0.f;
#pragma unroll
        for (int vi = 0; vi < 2; ++vi)
#pragma unroll
            for (int r = 0; r < 4; ++r) ss += O[vi][r] * O[vi][r];
        ss += __shfl_xor(ss, 16); ss += __shfl_xor(ss, 32);
        LAS float* SSQ = (LAS float*)(lds + L_SSQ);
        if (g == 0) SSQ[vh * 64 + 16 * it + c] = ss;
        __syncthreads();
        const int tok = 16 * it + c; const float rstd = 1.0f / sqrtf((SSQ[tok] + SSQ[64 + tok]) * (1.0f / 64.0f) + EPS);
#pragma unroll
        for (int vi = 0; vi < 2; ++vi) { const int v0 = 16 * (2 * vh + vi) + 4 * g;
            const u32x2 gw = *(const u32x2*)(P + (size_t)(row0 + tok) * NP + C_GG + h * 64 + v0);
            const f32x4 gn = *(const f32x4*)(a.g_gla_norm + v0);
            const float g0 = __uint_as_float(gw.x << 16), g1 = __uint_as_float(gw.x & 0xffff0000u), g2 = __uint_as_float(gw.y << 16), g3 = __uint_as_float(gw.y & 0xffff0000u);
            u32x2 w; w.x = cvtpk(O[vi][0] * rstd * gn[0] * silu(g0), O[vi][1] * rstd * gn[1] * silu(g1)); w.y = cvtpk(O[vi][2] * rstd * gn[2] * silu(g2), O[vi][3] * rstd * gn[3] * silu(g3));
            *(u32x2*)(MIX + (size_t)(row0 + tok) * DM + 512 + h * 64 + v0) = w; }
    }
}
#ifndef MK_LAUNCHES
#define MK_LAUNCHES 1
#endif
constexpr int NPHASE = 11;
__global__ void __launch_bounds__(512, 2) fwd_kernel(Args a) {
    extern __shared__ __attribute__((aligned(16))) unsigned char lds_raw[];
    lds8* lds = (lds8*)lds_raw;
    cg::grid_group grid = cg::this_grid();
    const int lo = a.ph_lo, hi = a.ph_hi;
    unsigned char* ws = a.ws;
#define IN(k) (lo <= (k) && (k) < hi)
#define SEAM(k) do { if (IN(k) && IN((k) + 1)) grid.sync(); } while (0)
    if (IN(0)) p0_prologue(a, lds);
    SEAM(0);
    if (IN(1)) p1_rows(a);
    SEAM(1);
    if (IN(2)) {
        pg8::Gemm g{(const pg8::bf16_t*)(ws + WS_H), (const pg8::bf16_t*)(ws + WS_WIN), MT, NP, DM}; pg8::StaticOrder S; S.init(MT, NP, (int)gridDim.x, (int)blockIdx.x);
        pg8::EpiPlain E{(pg8::bf16_t*)(ws + WS_P), NP};
        pg8::gemm_phase<pg8::EpiPlain, pg8::StaticOrder, true, true>(lds, g, S, E);
    }
    SEAM(2);
    if (IN(3)) { attn_phase(a, lds); __syncthreads(); gla_local_phase(a, lds); }
    SEAM(3);
    if (IN(4)) gla_scan_phase(a);
    SEAM(4);
    if (IN(5)) gla_out_phase(a, lds);
    SEAM(5);
    if (IN(6)) {
        pg8::Gemm g{(const pg8::bf16_t*)(ws + WS_MIX), (const pg8::bf16_t*)(ws + WS_WOUT), ML, DM, DM}; pg8::StaticOrder S; S.init(ML, DM, (int)gridDim.x, (int)blockIdx.x);
        pg8::EpiPlain E{(pg8::bf16_t*)(ws + WS_Y), DM};
        pg8::gemm_phase<pg8::EpiPlain, pg8::StaticOrder, true, true>(lds, g, S, E);
    }
    SEAM(6);
    if (IN(7)) p7_rows(a);
    SEAM(7);
    if (IN(8)) {
        pg8::Gemm g{(const pg8::bf16_t*)(ws + WS_H), (const pg8::bf16_t*)(ws + WS_WFI), ML, 2 * FF, DM}; pg8::StaticOrder S; S.init(ML, 2 * FF, (int)gridDim.x, (int)blockIdx.x);
        pg8::EpiSwiGLU E{(pg8::bf16_t*)(ws + WS_HM), FF};
        pg8::gemm_phase<pg8::EpiSwiGLU, pg8::StaticOrder, true, true>(lds, g, S, E);
    }
    SEAM(8);
    if (IN(9)) {
        pg8::Gemm g{(const pg8::bf16_t*)(ws + WS_HM), (const pg8::bf16_t*)(ws + WS_WFO), ML, DM, FF}; pg8::StaticOrder S; S.init(ML, DM, (int)gridDim.x, (int)blockIdx.x);
        pg8::EpiPlain E{(pg8::bf16_t*)(ws + WS_Y), DM};
        pg8::gemm_phase<pg8::EpiPlain, pg8::StaticOrder, true, true>(lds, g, S, E);
    }
    SEAM(9);
    if (IN(10)) p10_rows(a);
#undef IN
#undef SEAM
}

extern "C" void kernel_launch(void* const* d_in, const int* in_sizes, int n_in, void* d_out, int out_size, void* d_ws, size_t ws_size, hipStream_t stream) {
    static int grid = 0;
    if (grid == 0) {
        if (n_in != 20 || ws_size < WS_END) { fprintf(stderr, "kernel_launch: unexpected n_in %d or ws_size %zu (need %zu)\n", n_in, ws_size, (size_t)WS_END); grid = -1; return; }
        int dev = 0, cus = 0, per_cu = 0;
        hipGetDevice(&dev); hipDeviceGetAttribute(&cus, hipDeviceAttributeMultiprocessorCount, dev);
        hipFuncSetAttribute((const void*)fwd_kernel, hipFuncAttributeMaxDynamicSharedMemorySize, LDS_BYTES);
        if (hipOccupancyMaxActiveBlocksPerMultiprocessor(&per_cu, (const void*)fwd_kernel, 512, LDS_BYTES) != hipSuccess || per_cu < 1) { fprintf(stderr, "kernel_launch: occupancy query says %d\n", per_cu); per_cu = 1; }
        (void)hipGetLastError();
        grid = cus * 1;
    }
    if (grid < 0) return;
    Args a{};
    const float** pp = (const float**)&a;
    for (int i = 0; i < 20; ++i) pp[i] = (const float*)d_in[i];
    a.out = (float*)d_out; a.ws = (unsigned char*)d_ws;
#if MK_LAUNCHES == 1
    a.ph_lo = 0; a.ph_hi = NPHASE;
    void* args[] = {&a};
    hipError_t e = hipLaunchCooperativeKernel((const void*)fwd_kernel, dim3(grid), dim3(512), args, LDS_BYTES, stream);
    if (e != hipSuccess) fprintf(stderr, "cooperative launch failed: %s (grid %d)\n", hipGetErrorString(e), grid);
#else
    for (int ph = 0; ph < NPHASE; ++ph) { a.ph_lo = ph; a.ph_hi = ph + 1; hipLaunchKernelGGL(fwd_kernel, dim3(grid), dim3(512), LDS_BYTES, stream, a); }
#endif
}
```
